# Optimizing an MI355X kernel written in HIP

```python
import math
import jax, jax.numpy as jnp
from jax import lax
import numpy as np

D_MODEL = 1024
BATCH = 4
SEQ = 8192
DEPTH = 2

N_A_LAYERS = DEPTH // 2
N_B_LAYERS = DEPTH - N_A_LAYERS

EXPAND = 2
A_WIDTH = EXPAND * D_MODEL
A_GROUPS = 8
A_GROUP_DIM = A_WIDTH // A_GROUPS
CHUNK = 128

HEAD_DIM = 64
N_Q_HEADS = D_MODEL // HEAD_DIM
N_KV_HEADS = max(1, N_Q_HEADS // 8)
Q_PER_KV = N_Q_HEADS // N_KV_HEADS
B_WIDTH = N_Q_HEADS * HEAD_DIM
KV_WIDTH = N_KV_HEADS * HEAD_DIM
WINDOW = 128

REL_BUCKETS = 32
REL_MAX_DIST = 128

ALPHA = (2.0 * DEPTH) ** 0.25
BETA = (8.0 * DEPTH) ** -0.25
LN_EPS = 1e-5
NEG_INF = -1e30

kernel_name = "yoco_gmlp_swa_sink_hybrid"


def layer_norm(x, g, b):
    xf = x.astype(jnp.float32)
    mu = jnp.mean(xf, axis=-1, keepdims=True)
    var = jnp.mean(jnp.square(xf - mu), axis=-1, keepdims=True)
    y = (xf - mu) * lax.rsqrt(var + LN_EPS)
    return (y * g.astype(jnp.float32) + b.astype(jnp.float32)).astype(x.dtype)


def rel_bucket(d):
    max_exact = REL_BUCKETS // 2
    df = jnp.maximum(d, 1).astype(jnp.float32)
    large = max_exact + (jnp.log(df / max_exact) / math.log(REL_MAX_DIST / max_exact)
                         * (REL_BUCKETS - max_exact)).astype(jnp.int32)
    large = jnp.minimum(large, REL_BUCKETS - 1)
    return jnp.where(d < max_exact, d, large)


def sgu_branch(h, w_in, ln_g, ln_b, w_spatial, b_spatial, w_out):
    bsz, seq, _ = h.shape
    nc = seq // CHUNK
    u, v, z = jnp.split(h @ w_in, 3, axis=-1)
    v = layer_norm(v, ln_g, ln_b).reshape(bsz, nc, CHUNK, A_GROUPS, A_GROUP_DIM)
    tri = jnp.tril(jnp.ones((CHUNK, CHUNK), dtype=bool))
    ws = jnp.where(tri, w_spatial, jnp.zeros((), w_spatial.dtype))
    s = jnp.einsum("gts,bcsgd->bctgd", ws, v) + b_spatial.T[:, :, None]
    y = u * s.reshape(bsz, seq, A_WIDTH) * jax.nn.silu(z)
    return y @ w_out


def shared_kv_bands(h, w_kv):
    bsz, seq, _ = h.shape
    nc = seq // CHUNK
    k, v = jnp.split(h @ w_kv, 2, axis=-1)

    def band(t):
        t = t.reshape(bsz, seq, N_KV_HEADS, HEAD_DIM)
        prev = jnp.pad(t, ((0, 0), (CHUNK, 0), (0, 0), (0, 0)))[:, :seq]
        prev = prev.reshape(bsz, nc, CHUNK, N_KV_HEADS, HEAD_DIM)
        cur = t.reshape(bsz, nc, CHUNK, N_KV_HEADS, HEAD_DIM)
        return jnp.concatenate([prev, cur], axis=2)

    return band(k), band(v)


def band_bias_and_mask(rel_bias, nc):
    t = jnp.arange(CHUNK, dtype=jnp.int32)[:, None]
    j = jnp.arange(2 * CHUNK, dtype=jnp.int32)[None, :]
    d = t + CHUNK - j
    in_window = (d >= 0) & (d < WINDOW)
    bias = rel_bias[rel_bucket(jnp.clip(d, 0, REL_MAX_DIST - 1))]
    bias = jnp.transpose(bias, (2, 0, 1)).astype(jnp.float32)
    bias = bias.reshape(N_KV_HEADS, Q_PER_KV, 1, CHUNK, 2 * CHUNK)
    has_prev = (jnp.arange(nc)[:, None, None] > 0) | (j[None] >= CHUNK)
    mask = in_window[None] & has_prev
    return bias, mask


def swa_branch(h, k_band, v_band, bias, mask, w_in, sinks, w_out):
    bsz, seq, _ = h.shape
    nc = seq // CHUNK
    q, z = jnp.split(h @ w_in, 2, axis=-1)
    q = q.reshape(bsz, nc, CHUNK, N_KV_HEADS, Q_PER_KV, HEAD_DIM)
    scores = jnp.einsum("bcqkgd,bcjkd->bkgcqj", q, k_band)
    logits = jnp.where(mask, scores.astype(jnp.float32) * (HEAD_DIM ** -0.5) + bias, NEG_INF)
    sink = sinks.astype(jnp.float32).reshape(N_KV_HEADS, Q_PER_KV, 1, 1, 1)
    m = jnp.maximum(jnp.max(logits, axis=-1, keepdims=True), sink)
    e = jnp.exp(logits - m)
    p = e / (jnp.sum(e, axis=-1, keepdims=True) + jnp.exp(sink - m))
    o = jnp.einsum("bkgcqj,bcjkd->bcqkgd", p.astype(v_band.dtype), v_band)
    y = o.reshape(bsz, seq, B_WIDTH) * jax.nn.silu(z)
    return y @ w_out


def setup_inputs(seed: int = 0) -> dict:
    key = jax.random.key(seed)
    ks = jax.random.split(key, 16)
    f32 = jnp.float32
    nrm = lambda k, shape, s: jax.random.normal(k, shape, f32) * s
    return {
        "x": nrm(ks[0], (BATCH, SEQ, D_MODEL), 1.0),
        "w_in_a": nrm(ks[1], (N_A_LAYERS, D_MODEL, 3 * A_WIDTH), D_MODEL ** -0.5),
        "sgu_ln_g": 1.0 + nrm(ks[2], (N_A_LAYERS, A_WIDTH), 0.1),
        "sgu_ln_b": nrm(ks[3], (N_A_LAYERS, A_WIDTH), 0.1),
        "w_spatial": nrm(ks[4], (N_A_LAYERS, A_GROUPS, CHUNK, CHUNK), 0.1),
        "b_spatial": 1.0 + nrm(ks[5], (N_A_LAYERS, A_GROUPS, CHUNK), 0.1),
        "w_out_a": nrm(ks[6], (N_A_LAYERS, A_WIDTH, D_MODEL), BETA * A_WIDTH ** -0.5),
        "w_kv": nrm(ks[7], (D_MODEL, 2 * KV_WIDTH), D_MODEL ** -0.5),
        "w_in_b": nrm(ks[8], (N_B_LAYERS, D_MODEL, 2 * B_WIDTH), D_MODEL ** -0.5),
        "attn_sinks": nrm(ks[9], (N_B_LAYERS, N_Q_HEADS), 0.5),
        "rel_bias": nrm(ks[10], (REL_BUCKETS, N_Q_HEADS), 0.5),
        "w_out_b": nrm(ks[11], (N_B_LAYERS, B_WIDTH, D_MODEL), BETA * B_WIDTH ** -0.5),
        "post_ln_g": 1.0 + nrm(ks[12], (DEPTH, D_MODEL), 0.1),
        "post_ln_b": nrm(ks[13], (DEPTH, D_MODEL), 0.1),
    }


def reference(x, w_in_a, sgu_ln_g, sgu_ln_b, w_spatial, b_spatial, w_out_a, w_kv,
              w_in_b, attn_sinks, rel_bias, w_out_b, post_ln_g, post_ln_b):
    nc = x.shape[1] // CHUNK
    bias, mask = band_bias_and_mask(rel_bias, nc)
    h = x
    k_band = None
    v_band = None
    for layer in range(DEPTH):
        if layer < N_A_LAYERS:
            i = layer
            sub = sgu_branch(h, w_in_a[i], sgu_ln_g[i], sgu_ln_b[i], w_spatial[i],
                             b_spatial[i], w_out_a[i])
        else:
            i = layer - N_A_LAYERS
            if i == 0:
                k_band, v_band = shared_kv_bands(h, w_kv)
            sub = swa_branch(h, k_band, v_band, bias, mask, w_in_b[i], attn_sinks[i], w_out_b[i])
        h = layer_norm(ALPHA * h + sub, post_ln_g[layer], post_ln_b[layer])
    return h
```

```cpp
#include <hip/hip_runtime.h>
#include <cstdio>
#include <cstdint>

typedef short bf16x8 __attribute__((ext_vector_type(8)));
typedef float f32x4 __attribute__((ext_vector_type(4)));

constexpr int D_MODEL = 1024, BATCH = 4, SEQ = 8192, A_WIDTH = 2048, A_GROUPS = 8, CHUNK = 128;
constexpr int N_Q_HEADS = 16, HEAD_DIM = 64, KV_WIDTH = 128, B_WIDTH = 1024;
constexpr float ALPHA = 1.4142135623730951f, LN_EPS = 1e-5f;

__device__ __forceinline__ unsigned short f2bf(float f) { unsigned u = __builtin_bit_cast(unsigned, f); return (unsigned short)((u + 0x7fffu + ((u >> 16) & 1u)) >> 16); }

__global__ __launch_bounds__(256) void gemm_k(const float* __restrict__ A, int lda, const float* __restrict__ B, int ldb, float* __restrict__ C, int ldc, int K) {
    __shared__ __attribute__((aligned(16))) unsigned short sA[64][40];
    __shared__ __attribute__((aligned(16))) unsigned short sB[64][40];
    const int tid = threadIdx.x, lane = tid & 63, wid = tid >> 6, wm = wid >> 1, wn = wid & 1;
    const int m0 = blockIdx.y * 64, n0 = blockIdx.x * 64;
    f32x4 acc[2][2];
    for (int i = 0; i < 2; ++i) for (int j = 0; j < 2; ++j) acc[i][j] = (f32x4){0.f, 0.f, 0.f, 0.f};
    for (int k0 = 0; k0 < K; k0 += 32) {
        { const int r = tid >> 2, c = (tid & 3) * 8; const float* p = A + (size_t)(m0 + r) * lda + k0 + c;
          const float4 v0 = *(const float4*)p, v1 = *(const float4*)(p + 4);
          sA[r][c + 0] = f2bf(v0.x); sA[r][c + 1] = f2bf(v0.y); sA[r][c + 2] = f2bf(v0.z); sA[r][c + 3] = f2bf(v0.w);
          sA[r][c + 4] = f2bf(v1.x); sA[r][c + 5] = f2bf(v1.y); sA[r][c + 6] = f2bf(v1.z); sA[r][c + 7] = f2bf(v1.w); }
        { const int k = tid >> 3, n = (tid & 7) * 8; const float* p = B + (size_t)(k0 + k) * ldb + n0 + n;
          const float4 v0 = *(const float4*)p, v1 = *(const float4*)(p + 4);
          sB[n + 0][k] = f2bf(v0.x); sB[n + 1][k] = f2bf(v0.y); sB[n + 2][k] = f2bf(v0.z); sB[n + 3][k] = f2bf(v0.w);
          sB[n + 4][k] = f2bf(v1.x); sB[n + 5][k] = f2bf(v1.y); sB[n + 6][k] = f2bf(v1.z); sB[n + 7][k] = f2bf(v1.w); }
        __syncthreads();
        bf16x8 a[2], b[2];
        for (int i = 0; i < 2; ++i) a[i] = *(const bf16x8*)&sA[wm * 32 + i * 16 + (lane & 15)][(lane >> 4) * 8];
        for (int j = 0; j < 2; ++j) b[j] = *(const bf16x8*)&sB[wn * 32 + j * 16 + (lane & 15)][(lane >> 4) * 8];
        for (int i = 0; i < 2; ++i) for (int j = 0; j < 2; ++j) acc[i][j] = __builtin_amdgcn_mfma_f32_16x16x32_bf16(a[i], b[j], acc[i][j], 0, 0, 0);
        __syncthreads();
    }
    for (int i = 0; i < 2; ++i) for (int j = 0; j < 2; ++j) for (int r = 0; r < 4; ++r)
        C[(size_t)(m0 + wm * 32 + i * 16 + (lane >> 4) * 4 + r) * ldc + n0 + wn * 32 + j * 16 + (lane & 15)] = acc[i][j][r];
}

__device__ __forceinline__ float wave_sum(float v) {
#pragma unroll
    for (int o = 1; o < 64; o <<= 1) v += __shfl_xor(v, o);
    return v;
}
__global__ __launch_bounds__(256) void ln_k(const float* a, int lda, float alpha, const float* r, int ldr, float* out, int ldo, int n, const float* __restrict__ g, const float* __restrict__ be, int nrows) {
    const int row = blockIdx.x * 4 + (threadIdx.x >> 6), lane = threadIdx.x & 63;
    if (row >= nrows) return;
    const float* ap = a + (size_t)row * lda; const float* rp = r ? r + (size_t)row * ldr : nullptr;
    float s = 0.f;
    for (int i = lane; i < n; i += 64) s += alpha * ap[i] + (rp ? rp[i] : 0.f);
    const float mean = wave_sum(s) / (float)n;
    float q = 0.f;
    for (int i = lane; i < n; i += 64) { const float d = alpha * ap[i] + (rp ? rp[i] : 0.f) - mean; q += d * d; }
    const float rstd = 1.0f / sqrtf(wave_sum(q) / (float)n + LN_EPS);
    float* op = out + (size_t)row * ldo;
    for (int i = lane; i < n; i += 64) { const float v = alpha * ap[i] + (rp ? rp[i] : 0.f); op[i] = (v - mean) * rstd * g[i] + be[i]; }
}

__global__ __launch_bounds__(256) void sgu_k(float* uvz, const float* __restrict__ wsp, const float* __restrict__ bsp) {
    const int c = blockIdx.x, g = blockIdx.y, d = threadIdx.x;
    float* base = uvz + (size_t)c * CHUNK * 6144;
    const float* W = wsp + (size_t)g * CHUNK * CHUNK;
    const int col = g * 256 + d;
    for (int t = 0; t < CHUNK; ++t) {
        float acc = 0.f;
        for (int s = 0; s <= t; ++s) acc += W[t * CHUNK + s] * base[(size_t)s * 6144 + 2048 + col];
        acc += bsp[g * CHUNK + t];
        const float u = base[(size_t)t * 6144 + col], z = base[(size_t)t * 6144 + 4096 + col];
        base[(size_t)t * 6144 + col] = u * acc * (z / (1.f + __expf(-z)));
    }
}

__global__ __launch_bounds__(256) void attn_k(float* qz, const float* __restrict__ kv, const float* __restrict__ sinks, const float* __restrict__ relb) {
    __shared__ int bucket[128];
    if (threadIdx.x < 128) { const int d = threadIdx.x; int b;
        if (d < 16) b = d; else { b = 16 + (int)(logf((float)d / 16.f) / logf(8.f) * 16.f); if (b > 31) b = 31; }
        bucket[d] = b; }
    __syncthreads();
    const int lane = threadIdx.x & 63, h = blockIdx.y * 4 + (threadIdx.x >> 6), t = blockIdx.x * 64 + lane, kvh = h >> 3;
    float q[64], o[64];
    float* qp = qz + (size_t)t * 2048 + h * 64;
#pragma unroll
    for (int i = 0; i < 64; ++i) { q[i] = qp[i]; o[i] = 0.f; }
    float m = sinks[h], l = 1.f;
    const int dmax = t < 127 ? t : 127;
    for (int dr = 0; dr <= dmax; ++dr) {
        const float* kp = kv + (size_t)(t - dr) * 256 + kvh * 64; const float* vp = kp + 128;
        float dot = 0.f;
#pragma unroll
        for (int i = 0; i < 64; ++i) dot += q[i] * kp[i];
        const float lg = dot * 0.125f + relb[bucket[dr] * 16 + h];
        if (lg > m) { const float sc = __expf(m - lg); l *= sc;
#pragma unroll
            for (int i = 0; i < 64; ++i) o[i] *= sc;
            m = lg; }
        const float p = __expf(lg - m); l += p;
#pragma unroll
        for (int i = 0; i < 64; ++i) o[i] += p * vp[i];
    }
    const float inv = 1.f / l;
    const float* zp = qz + (size_t)t * 2048 + 1024 + h * 64;
#pragma unroll
    for (int i = 0; i < 64; ++i) { const float z = zp[i]; qp[i] = o[i] * inv * (z / (1.f + __expf(-z))); }
}

extern "C" void kernel_launch(void* const* d_in, const int* in_sizes, int n_in, void* d_out, int out_size, void* d_ws, size_t ws_size, hipStream_t stream) {
    const float* x = (const float*)d_in[0]; const float* w_in_a = (const float*)d_in[1]; const float* sgu_g = (const float*)d_in[2]; const float* sgu_b = (const float*)d_in[3];
    const float* w_sp = (const float*)d_in[4]; const float* b_sp = (const float*)d_in[5]; const float* w_out_a = (const float*)d_in[6]; const float* w_kv = (const float*)d_in[7];
    const float* w_in_b = (const float*)d_in[8]; const float* sinks = (const float*)d_in[9]; const float* relb = (const float*)d_in[10]; const float* w_out_b = (const float*)d_in[11];
    const float* pg = (const float*)d_in[12]; const float* pb = (const float*)d_in[13];
    float* out = (float*)d_out; char* ws = (char*)d_ws;
    const size_t MiB = 1u << 20;
    float* uvz = (float*)(ws); float* sub = (float*)(ws + 192 * MiB); float* h1 = (float*)(ws + 224 * MiB); float* kv = (float*)(ws + 256 * MiB);
    float* qz = (float*)(ws + 264 * MiB); float* sub2 = (float*)(ws + 328 * MiB);
    const int R = SEQ;
    for (int b = 0; b < BATCH; ++b) {
        const float* xb = x + (size_t)b * R * D_MODEL; float* ob = out + (size_t)b * R * D_MODEL;
        gemm_k<<<dim3(6144 / 64, R / 64), 256, 0, stream>>>(xb, D_MODEL, w_in_a, 6144, uvz, 6144, D_MODEL);
        ln_k<<<R / 4, 256, 0, stream>>>(uvz + 2048, 6144, 1.f, nullptr, 0, uvz + 2048, 6144, A_WIDTH, sgu_g, sgu_b, R);
        sgu_k<<<dim3(R / CHUNK, A_GROUPS), 256, 0, stream>>>(uvz, w_sp, b_sp);
        gemm_k<<<dim3(D_MODEL / 64, R / 64), 256, 0, stream>>>(uvz, 6144, w_out_a, D_MODEL, sub, D_MODEL, A_WIDTH);
        ln_k<<<R / 4, 256, 0, stream>>>(xb, D_MODEL, ALPHA, sub, D_MODEL, h1, D_MODEL, D_MODEL, pg, pb, R);
        gemm_k<<<dim3(256 / 64, R / 64), 256, 0, stream>>>(h1, D_MODEL, w_kv, 256, kv, 256, D_MODEL);
        gemm_k<<<dim3(2048 / 64, R / 64), 256, 0, stream>>>(h1, D_MODEL, w_in_b, 2048, qz, 2048, D_MODEL);
        attn_k<<<dim3(R / 64, N_Q_HEADS / 4), 256, 0, stream>>>(qz, kv, sinks, relb);
        gemm_k<<<dim3(D_MODEL / 64, R / 64), 256, 0, stream>>>(qz, 2048, w_out_b, D_MODEL, sub2, D_MODEL, B_WIDTH);
        ln_k<<<R / 4, 256, 0, stream>>>(h1, D_MODEL, ALPHA, sub2, D_MODEL, ob, D_MODEL, D_MODEL, pg + D_MODEL, pb + D_MODEL, R);
    }
}
```

```cpp
#include <hip/hip_runtime.h>
#include <cstdio>
#include <cstdint>
namespace pg8 {
#define PG8_LAS __attribute__((address_space(3)))
typedef unsigned short bf16_t;
typedef short bf16x8 __attribute__((ext_vector_type(8)));
typedef float f32x4 __attribute__((ext_vector_type(4)));
typedef unsigned u32x4 __attribute__((ext_vector_type(4)));
constexpr int BM = 256, BK = 64, HALF = 128, HTB = HALF * BK * 2  , STAGE_BYTES = 8 * HTB, NXCD = 8, WGM = 8;

__host__ __device__ __forceinline__ int lds_byte(int r, int c) { const int st = (r >> 4) * 2 + (c >> 5), rr = r & 15, cc = c & 31, ob = rr * 64 + cc * 2; return st * 1024 + (ob ^ (((ob >> 9) & 1) << 5)); }
__host__ __device__ __forceinline__ void stage_rc(int b, int& R, int& C) { const int st = b / 1024, sb = b % 1024, swz = sb ^ (((sb >> 9) & 1) << 5); R = (st >> 1) * 16 + swz / 64; C = (st & 1) * 32 + (swz % 64) / 2; }
__host__ __device__ __forceinline__ int perm32(int rho) { const int n = rho >> 4, i = rho & 15; return 8 * (i >> 2) + 4 * n + (i & 3); }

struct Unit { int pm, pn; };
struct Gemm { const bf16_t* A; const bf16_t* Bt; int M, N, K, lda, ldb; };

struct StaticOrder {
    int nM, nN, nwg, G, c;
    __host__ __device__ void init(int M, int N, int G_, int c_) { nM = M / BM; nN = N / BM; nwg = nM * nN; G = G_; c = c_; }
    __host__ __device__ bool next(int i, Unit& u) const {
        const long L = (long)i * G + c; if (L >= nwg) return false;
        int wgid = (int)L; { const int q = nwg / NXCD, r = nwg % NXCD, xcd = wgid % NXCD, off = wgid / NXCD; wgid = (xcd < r ? xcd * (q + 1) : r * (q + 1) + (xcd - r) * q) + off; }
        const int nig = WGM * nN, gid = wgid / nig, fm = gid * WGM, gsz = (nM - fm) < WGM ? (nM - fm) : WGM;
        u.pm = fm + ((wgid % nig) % gsz); u.pn = (wgid % nig) / gsz; return true;
    }
    __device__ __forceinline__ void a_ready(const Unit&) const {}
    __device__ __forceinline__ void done(const Unit&) const {}
};

__device__ __forceinline__ unsigned cvt_pk_bf16(float lo, float hi) { unsigned r; asm volatile("v_cvt_pk_bf16_f32 %0, %1, %2" : "=v"(r) : "v"(lo), "v"(hi)); return r; }
typedef float f32x2 __attribute__((ext_vector_type(2)));
template <class Epi, class Sched, bool ALIGN_EPI = false, bool SP2 = false>
__device__ __forceinline__ void gemm_phase(PG8_LAS unsigned char* lds, const Gemm g, const Sched& S, const Epi& E) {
    const int tid = threadIdx.x, wid = __builtin_amdgcn_readfirstlane(tid >> 6), lane = tid & 63, wr = wid >> 2, wc = wid & 3, fr = lane & 15, fq = lane >> 4;
    const int K = g.K, nt = K / BK;
    unsigned voffA[2], voffB[2];
#pragma unroll
    for (int i = 0; i < 2; ++i) { int R, C; stage_rc(tid * 16 + i * 8192, R, C); const int Rb = Epi::PERM ? ((R & ~31) + perm32(R & 31)) : R;
        voffA[i] = (unsigned)(R * g.lda + C) * 2u; voffB[i] = (unsigned)(Rb * g.ldb + C) * 2u; }
    const size_t kstep = (size_t)(BK * 2);
    const size_t hstepA = (size_t)HALF * g.lda * 2, hstepB = (size_t)HALF * g.ldb * 2;
    const size_t tstepA = 2 * hstepA, tstepB = 2 * hstepB;
    const unsigned ldsw = (unsigned)wid * 1024u;
    const int aoff = lds_byte(wr * 64 + fr, fq * 8), boff = lds_byte(wc * 32 + fr, fq * 8);
#define PG8_SA(b, h) (((b) * 2 + (h)) * HTB)
#define PG8_SB(b, h) ((4 + (b) * 2 + (h)) * HTB)
#define PG8_STAGE(bufoff, gbase, voff) do { _Pragma("unroll") for (int _i = 0; _i < 2; ++_i) \
        __builtin_amdgcn_global_load_lds((const unsigned*)((const char*)(gbase) + (voff)[_i]), (PG8_LAS unsigned*)(lds + (bufoff) + ldsw + _i * 8192), 16, 0, 0); } while (0)
#define PG8_LDA(dst, b, h) do { _Pragma("unroll") for (int m = 0; m < 4; ++m) _Pragma("unroll") for (int k = 0; k < 2; ++k) dst[m][k] = *(const PG8_LAS bf16x8*)(lds + PG8_SA(b, h) + aoff + m * 2048 + k * 1024); } while (0)
#define PG8_LDB(dst, b, h) do { _Pragma("unroll") for (int n = 0; n < 2; ++n) _Pragma("unroll") for (int k = 0; k < 2; ++k) dst[n][k] = *(const PG8_LAS bf16x8*)(lds + PG8_SB(b, h) + boff + n * 2048 + k * 1024); } while (0)
#define PG8_MMA(ai, bj, At, Bt) do { __builtin_amdgcn_s_setprio(1); _Pragma("unroll") for (int m = 0; m < 4; ++m) _Pragma("unroll") for (int n = 0; n < 2; ++n) _Pragma("unroll") for (int k = 0; k < 2; ++k) \
        acc[ai][bj][m][n] = __builtin_amdgcn_mfma_f32_16x16x32_bf16(Bt[n][k], At[m][k], acc[ai][bj][m][n], 0, 0, 0); __builtin_amdgcn_s_setprio(0); } while (0)
#define PG8_WAIT_V(n) asm volatile("s_waitcnt vmcnt(" #n ")" ::: "memory")
#define PG8_WAIT_L(n) asm volatile("s_waitcnt lgkmcnt(" #n ")" ::: "memory")
#define PG8_BAR __builtin_amdgcn_s_barrier()
#define PG8_SCHED __builtin_amdgcn_sched_barrier(0)
    Unit cur, nxt; int ui = 0;
    if (!S.next(0, cur)) return;
    f32x4 acc[2][2][4][2];
#pragma unroll
    for (int a = 0; a < 2; ++a)
#pragma unroll
        for (int b = 0; b < 2; ++b)
#pragma unroll
            for (int m = 0; m < 4; ++m)
#pragma unroll
                for (int n = 0; n < 2; ++n) acc[a][b][m][n] = (f32x4){0.f, 0.f, 0.f, 0.f};
    bf16x8 At[4][2], B0[2][2], B1[2][2];
    const char* cA = (const char*)g.A + (size_t)cur.pm * tstepA; const char* cB = (const char*)g.Bt + (size_t)cur.pn * tstepB;
    S.a_ready(cur);
    if constexpr (SP2) {
        PG8_STAGE(PG8_SB(0, 0), cB, voffB); PG8_STAGE(PG8_SB(0, 1), cB + hstepB, voffB); PG8_STAGE(PG8_SA(0, 0), cA, voffA); PG8_STAGE(PG8_SA(0, 1), cA + hstepA, voffA);
        if (wr == 1) PG8_BAR;
        PG8_WAIT_V(2); PG8_BAR;
        PG8_STAGE(PG8_SB(1, 0), cB + kstep, voffB); PG8_STAGE(PG8_SA(1, 0), cA + kstep, voffA); PG8_STAGE(PG8_SB(1, 1), cB + hstepB + kstep, voffB);
        PG8_WAIT_V(6); PG8_BAR;
    } else {
        PG8_STAGE(PG8_SB(0, 0), cB, voffB); PG8_STAGE(PG8_SA(0, 0), cA, voffA); PG8_STAGE(PG8_SB(0, 1), cB + hstepB, voffB); PG8_STAGE(PG8_SA(0, 1), cA + hstepA, voffA);
        if (wr == 1) PG8_BAR;
        PG8_WAIT_V(4); PG8_BAR;
        PG8_STAGE(PG8_SB(1, 0), cB + kstep, voffB); PG8_STAGE(PG8_SA(1, 0), cA + kstep, voffA); PG8_STAGE(PG8_SB(1, 1), cB + hstepB + kstep, voffB);
        PG8_WAIT_V(6); PG8_BAR;
    }
    for (;;) {
        const bool has_next = S.next(ui + 1, nxt);
        const char* nA = has_next ? (const char*)g.A + (size_t)nxt.pm * tstepA : cA; const char* nB = has_next ? (const char*)g.Bt + (size_t)nxt.pn * tstepB : cB;
        for (int t = 0; t < nt; t += 2) {
            const bool last = (t == nt - 2);
            const char* a1 = cA + (size_t)(t + 1) * kstep;
            const char* a2 = last ? nA : cA + (size_t)(t + 2) * kstep; const char* b2 = last ? nB : cB + (size_t)(t + 2) * kstep;
            const char* a3 = a2 + kstep; const char* b3 = b2 + kstep;
            if (last && has_next) S.a_ready(nxt);
            if constexpr (SP2) {
            PG8_LDB(B0, 0, 0); PG8_LDB(B1, 0, 1); PG8_SCHED; PG8_LDA(At, 0, 0); PG8_STAGE(PG8_SA(1, 1), a1 + hstepA, voffA);
            PG8_WAIT_V(8); PG8_WAIT_L(0); PG8_BAR; PG8_MMA(0, 0, At, B0); PG8_MMA(0, 1, At, B1); PG8_BAR; PG8_SCHED;
            PG8_LDA(At, 0, 1); PG8_STAGE(PG8_SB(0, 0), b2, voffB); PG8_STAGE(PG8_SB(0, 1), b2 + hstepB, voffB); PG8_STAGE(PG8_SA(0, 0), a2, voffA);
            PG8_WAIT_V(8); PG8_WAIT_L(0); PG8_BAR; PG8_MMA(1, 0, At, B0); PG8_MMA(1, 1, At, B1); PG8_BAR; PG8_SCHED;
            PG8_LDB(B0, 1, 0); PG8_LDB(B1, 1, 1); PG8_SCHED; PG8_LDA(At, 1, 0); PG8_STAGE(PG8_SA(0, 1), a2 + hstepA, voffA);
            PG8_WAIT_V(8); PG8_WAIT_L(0); PG8_BAR; PG8_MMA(0, 0, At, B0); PG8_MMA(0, 1, At, B1); PG8_BAR; PG8_SCHED;
            PG8_LDA(At, 1, 1); PG8_STAGE(PG8_SB(1, 0), b3, voffB); PG8_STAGE(PG8_SB(1, 1), b3 + hstepB, voffB); PG8_STAGE(PG8_SA(1, 0), a3, voffA);
            PG8_WAIT_V(8); PG8_WAIT_L(0); PG8_BAR; PG8_MMA(1, 0, At, B0); PG8_MMA(1, 1, At, B1); PG8_BAR; PG8_SCHED;
            } else {
            PG8_LDB(B0, 0, 0); PG8_SCHED; PG8_LDA(At, 0, 0); PG8_STAGE(PG8_SA(1, 1), a1 + hstepA, voffA);
            PG8_WAIT_L(8); PG8_BAR; PG8_WAIT_L(0); PG8_MMA(0, 0, At, B0); PG8_BAR; PG8_SCHED;
            PG8_LDB(B1, 0, 1); PG8_STAGE(PG8_SB(0, 0), b2, voffB);
            PG8_BAR; PG8_WAIT_L(0); PG8_MMA(0, 1, At, B1); PG8_BAR;
            PG8_LDA(At, 0, 1); PG8_STAGE(PG8_SA(0, 0), a2, voffA);
            PG8_BAR; PG8_WAIT_L(0); PG8_MMA(1, 0, At, B0); PG8_BAR; PG8_SCHED;
            PG8_STAGE(PG8_SB(0, 1), b2 + hstepB, voffB);
            PG8_WAIT_V(6); PG8_BAR; PG8_MMA(1, 1, At, B1); PG8_BAR;
            PG8_LDB(B0, 1, 0); PG8_SCHED; PG8_LDA(At, 1, 0); PG8_STAGE(PG8_SA(0, 1), a2 + hstepA, voffA);
            PG8_WAIT_L(8); PG8_BAR; PG8_WAIT_L(0); PG8_MMA(0, 0, At, B0); PG8_BAR; PG8_SCHED;
            PG8_LDB(B1, 1, 1); PG8_STAGE(PG8_SB(1, 0), b3, voffB);
            PG8_BAR; PG8_WAIT_L(0); PG8_MMA(0, 1, At, B1); PG8_BAR;
            PG8_LDA(At, 1, 1); PG8_STAGE(PG8_SA(1, 0), a3, voffA);
            PG8_BAR; PG8_WAIT_L(0); PG8_MMA(1, 0, At, B0); PG8_BAR; PG8_SCHED;
            PG8_STAGE(PG8_SB(1, 1), b3 + hstepB, voffB);
            PG8_WAIT_V(6); PG8_BAR; PG8_MMA(1, 1, At, B1); PG8_BAR;
            }
        }
        if constexpr (ALIGN_EPI) { if (wr == 0) PG8_BAR; }
        if constexpr (!Epi::AFTER_DRAIN) { E(acc, cur, wr, wc, fr, fq); S.done(cur); }
        if (!has_next) break;
#pragma unroll
        for (int a = 0; a < 2; ++a)
#pragma unroll
            for (int b = 0; b < 2; ++b)
#pragma unroll
                for (int m = 0; m < 4; ++m)
#pragma unroll
                    for (int n = 0; n < 2; ++n) acc[a][b][m][n] = (f32x4){0.f, 0.f, 0.f, 0.f};
        cur = nxt; cA = nA; cB = nB; ++ui;
        if constexpr (ALIGN_EPI) { if (wr == 1) PG8_BAR; }
    }
    PG8_WAIT_V(0);
    if constexpr (!ALIGN_EPI) { if (wr == 0) PG8_BAR; }
    PG8_BAR;
    if constexpr (Epi::AFTER_DRAIN) { E.fused(acc, cur, wr, wc, fr, fq, lds, wid, lane); S.done(cur); }
#undef PG8_SA
#undef PG8_SB
#undef PG8_STAGE
#undef PG8_LDA
#undef PG8_LDB
#undef PG8_MMA
#undef PG8_WAIT_V
#undef PG8_WAIT_L
#undef PG8_BAR
#undef PG8_SCHED
}
}
#define GAS __attribute__((address_space(1)))
#define LAS __attribute__((address_space(3)))
typedef unsigned short bf16;
typedef unsigned v4u __attribute__((ext_vector_type(4)));
typedef float f32x4 __attribute__((ext_vector_type(4)));
typedef short bf16x8 __attribute__((ext_vector_type(8)));
typedef GAS unsigned gu32;
typedef GAS unsigned long long gu64;
#define RLX_AGENT __ATOMIC_RELAXED, __HIP_MEMORY_SCOPE_AGENT
#define LDS_WAIT() asm volatile("s_waitcnt lgkmcnt(0)" ::: "memory")
#define VM_WAIT() asm volatile("s_waitcnt vmcnt(0)" ::: "memory")
__device__ __forceinline__ unsigned long long rt() { return __builtin_amdgcn_s_memrealtime(); }
__device__ __forceinline__ unsigned f2bf(float f) { unsigned u = __builtin_bit_cast(unsigned, f); return (u + 0x7fffu + ((u >> 16) & 1u)) >> 16; }
__device__ __forceinline__ unsigned pk2(float lo, float hi) { return f2bf(lo) | (f2bf(hi) << 16); }
#define XB_TMO      128
#define XB_XCNT(j)  (256  + 64 * (j))
#define XB_XSUB(j)  (1280 + 64 * (j))
#define XB_XGEN(j)  (2304 + 64 * (j))
#define XB_TOP      3328
#define XB_TOPGEN   3392
#define XCD_BAR_WORDS 3456
#define XB_SPIN_CAP (1u << 18)

__device__ __forceinline__ unsigned xb_ld(unsigned* p)              { return __hip_atomic_load(p, __ATOMIC_RELAXED, __HIP_MEMORY_SCOPE_AGENT); }
__device__ __forceinline__ unsigned xb_add(unsigned* p, unsigned v) { return __hip_atomic_fetch_add(p, v, __ATOMIC_RELAXED, __HIP_MEMORY_SCOPE_AGENT); }
__device__ __forceinline__ unsigned xb_xcc_id() { return (unsigned)__builtin_amdgcn_s_getreg((3 << 11) | 20) & 0xFu; }
#define XB_SPIN(cond, bar) do { unsigned _sp = 0; while (cond) { __builtin_amdgcn_s_sleep(1); \
    if ((++_sp & 255u) == 0u) { if (xb_ld(&(bar)[XB_TMO])) break; if (_sp > XB_SPIN_CAP) { atomicAdd(&(bar)[XB_TMO], 1u); break; } } } } while (0)

struct XcdBarrier {
    unsigned* bar; unsigned x;
    volatile LAS unsigned* st;
};

__device__ __forceinline__ XcdBarrier xcd_barrier_post(unsigned* bar, volatile LAS unsigned* st) {
    XcdBarrier b; b.bar = bar; b.x = xb_xcc_id(); b.st = st;
    if (threadIdx.x == 0) (void)xb_add(&bar[XB_XCNT(b.x)], 1u);
    return b;
}
__device__ __forceinline__ void xcd_barrier_complete(unsigned* bar, unsigned x, unsigned& nloc, unsigned& nx) {
    const unsigned G = gridDim.x * gridDim.y * gridDim.z;
    unsigned sum, cnt, mine, sp = 0u;
    for (;;) {
        sum = 0u; cnt = 0u; mine = 0u;
#pragma unroll
        for (unsigned j = 0; j < 16; ++j) { const unsigned c = xb_ld(&bar[XB_XCNT(j)]); sum += c; cnt += (c > 0u) ? 1u : 0u; mine = (j == x) ? c : mine; }
        if (sum == G) break;
        __builtin_amdgcn_s_sleep(1);
        if ((++sp & 255u) == 0u) { if (xb_ld(&bar[XB_TMO])) break; if (sp > XB_SPIN_CAP) { atomicAdd(&bar[XB_TMO], 1u); break; } }
    }
    nloc = mine > 0u ? mine : 1u; nx = cnt > 0u ? cnt : 1u;
}

__device__ __forceinline__ void xcd_barrier(const XcdBarrier& b) {
    asm volatile("s_waitcnt vmcnt(0)" ::: "memory");
    __syncthreads();
    if (threadIdx.x == 0) {
        unsigned* bar = b.bar;
        __builtin_amdgcn_s_waitcnt(0);
        unsigned nloc = b.st[0], nx = b.st[1];
        if (nloc == 0u) { xcd_barrier_complete(bar, b.x, nloc, nx); b.st[0] = nloc; b.st[1] = nx; }
        const unsigned old = xb_add(&bar[XB_XSUB(b.x)], 1u);
        const unsigned gen = old / nloc;
        if (old + 1u == (gen + 1u) * nloc) {
            __builtin_amdgcn_fence(__ATOMIC_RELEASE, "agent");
            asm volatile("s_waitcnt vmcnt(0)" ::: "memory");
            const unsigned og = xb_add(&bar[XB_TOP], 1u);
            const unsigned tg = og / nx;
            if (og + 1u == (tg + 1u) * nx) xb_add(&bar[XB_TOPGEN], 1u);
            else XB_SPIN(xb_ld(&bar[XB_TOPGEN]) == tg, bar);
            __builtin_amdgcn_fence(__ATOMIC_ACQUIRE, "agent");
            xb_add(&bar[XB_XGEN(b.x)], 1u);
            asm volatile("s_waitcnt vmcnt(0)" ::: "memory");
        } else {
            XB_SPIN(xb_ld(&bar[XB_XGEN(b.x)]) == gen, bar);
            __builtin_amdgcn_fence(__ATOMIC_ACQUIRE, "agent");
            asm volatile("s_waitcnt vmcnt(0)" ::: "memory");
        }
    }
    __syncthreads();
}

constexpr int NWAVES = 8;
constexpr int DM = 1024, NB = 4, SEQ = 8192, MTOK = NB * SEQ, AW = 2048, NGRP = 8, CH = 128, NHEAD = 16, HD = 64;
constexpr float ALPHA = 1.4142135623730951f, LN_EPS = 1e-5f, LOG2E = 1.4426950408889634f;
constexpr float QSCALE = 0.125f * LOG2E;

constexpr size_t MiB = 1u << 20;
constexpr size_t WS_CTL = 0, CTL_ZERO_BYTES = 1 * MiB;
constexpr size_t WS_WUZ = 2 * MiB, WS_WV = 10 * MiB, WS_WOA = 14 * MiB, WS_WQZ = 18 * MiB, WS_WKV = 22 * MiB, WS_WOB = 23 * MiB, WS_VEC = 25 * MiB;
constexpr size_t WS_VST = 26 * MiB, WS_TST = 30 * MiB;
constexpr size_t WS_XB = 34 * MiB;
constexpr size_t WS_UZ = 98 * MiB;
constexpr size_t WS_VT = 354 * MiB;
constexpr size_t WS_END = 482 * MiB;
constexpr int CW_BAR = 4096;

constexpr int RING_BYTES = 131072, LDSCTL_OFF = RING_BYTES, MISC_OFF = LDSCTL_OFF + 320, LDS_BYTES = 147456;

typedef unsigned u32x2 __attribute__((ext_vector_type(2)));
typedef unsigned u32x4 __attribute__((ext_vector_type(4)));
typedef short s16x4 __attribute__((ext_vector_type(4)));
typedef float f32x16 __attribute__((ext_vector_type(16)));
typedef float f32x2v __attribute__((ext_vector_type(2)));

__device__ __forceinline__ float bf2f(unsigned short b) { return __builtin_bit_cast(float, (unsigned)b << 16); }
__device__ __forceinline__ float bflo(unsigned w) { return __builtin_bit_cast(float, w << 16); }
__device__ __forceinline__ float bfhi(unsigned w) { return __builtin_bit_cast(float, w & 0xffff0000u); }
__device__ __forceinline__ float silu_f(float z) { return z / (1.f + __expf(-z)); }
__device__ __forceinline__ float wave_sum(float v) {
#pragma unroll
    for (int o = 1; o < 64; o <<= 1) v += __shfl_xor(v, o);
    return v;
}

namespace pg8 {
struct EpiStore {
    static constexpr bool PERM = true, AFTER_DRAIN = false;
    bf16_t* O; int ldc;
    __device__ __forceinline__ void operator()(const f32x4 (&acc)[2][2][4][2], const Unit& u, int wr, int wc, int fr, int fq) const {
        const int row0 = u.pm * BM + wr * 64 + fr, col0 = u.pn * BM + wc * 32 + 8 * fq;
#pragma unroll
        for (int ai = 0; ai < 2; ++ai)
#pragma unroll
            for (int m = 0; m < 4; ++m) { bf16_t* rowp = O + (size_t)(row0 + ai * HALF + m * 16) * ldc + col0;
#pragma unroll
                for (int bj = 0; bj < 2; ++bj) { const f32x4 v0 = acc[ai][bj][m][0], v1 = acc[ai][bj][m][1];
                    u32x4 w; w.x = cvt_pk_bf16(v0[0], v0[1]); w.y = cvt_pk_bf16(v0[2], v0[3]); w.z = cvt_pk_bf16(v1[0], v1[1]); w.w = cvt_pk_bf16(v1[2], v1[3]);
                    *(u32x4*)(rowp + bj * HALF) = w; } }
    }
};
struct EpiVT {
    static constexpr bool PERM = true, AFTER_DRAIN = false;
    bf16_t* O; int ldc; float* stats;
    __device__ __forceinline__ void operator()(const f32x4 (&acc)[2][2][4][2], const Unit& u, int wr, int wc, int fr, int fq) const {
        const int row0 = u.pm * BM + wr * 64 + fr, col0 = u.pn * BM + wc * 32 + 8 * fq;
        f32x4 s[2][2], q[2][2];
#pragma unroll
        for (int bj = 0; bj < 2; ++bj)
#pragma unroll
            for (int n = 0; n < 2; ++n) { s[bj][n] = (f32x4){0.f, 0.f, 0.f, 0.f}; q[bj][n] = (f32x4){0.f, 0.f, 0.f, 0.f}; }
#pragma unroll
        for (int ai = 0; ai < 2; ++ai)
#pragma unroll
            for (int m = 0; m < 4; ++m) { bf16_t* rowp = O + (size_t)(row0 + ai * HALF + m * 16) * ldc + col0;
#pragma unroll
                for (int bj = 0; bj < 2; ++bj) { const f32x4 v0 = acc[ai][bj][m][0], v1 = acc[ai][bj][m][1];
                    s[bj][0] += v0; s[bj][1] += v1; q[bj][0] += v0 * v0; q[bj][1] += v1 * v1;
                    u32x4 w; w.x = cvt_pk_bf16(v0[0], v0[1]); w.y = cvt_pk_bf16(v0[2], v0[3]); w.z = cvt_pk_bf16(v1[0], v1[1]); w.w = cvt_pk_bf16(v1[2], v1[3]);
                    *(u32x4*)(rowp + bj * HALF) = w; } }
        const int slot = u.pm * 2 + wr;
#pragma unroll
        for (int bj = 0; bj < 2; ++bj)
#pragma unroll
            for (int n = 0; n < 2; ++n)
#pragma unroll
                for (int e = 0; e < 4; ++e) { float a = s[bj][n][e], b = q[bj][n][e];
#pragma unroll
                    for (int o = 1; o < 16; o <<= 1) { a += __shfl_xor(a, o); b += __shfl_xor(b, o); }
                    if (fr == 0) { const int tok = col0 + bj * HALF + 4 * n + e; *(f32x2v*)(stats + (size_t)tok * 32 + slot * 2) = (f32x2v){a, b}; } }
    }
};
struct EpiT1 {
    static constexpr bool PERM = false, AFTER_DRAIN = false;
    const float* resid; float* t1; bf16_t* t1b; float* stats; float alpha;
    __device__ __forceinline__ void operator()(const f32x4 (&acc)[2][2][4][2], const Unit& u, int wr, int wc, int fr, int fq) const {
        const int col0 = u.pn * BM + wc * 32 + 4 * fq, slot = u.pn * 4 + wc;
#pragma unroll
        for (int ai = 0; ai < 2; ++ai)
#pragma unroll
            for (int m = 0; m < 4; ++m) { const int row = u.pm * BM + ai * HALF + wr * 64 + m * 16 + fr; const size_t off = (size_t)row * 1024 + col0;
                float sa = 0.f, sq = 0.f;
#pragma unroll
                for (int bj = 0; bj < 2; ++bj)
#pragma unroll
                    for (int n = 0; n < 2; ++n) { const f32x4 xr = *(const f32x4*)(resid + off + bj * HALF + n * 16); const f32x4 v = xr * alpha + acc[ai][bj][m][n];
                        *(f32x4*)(t1 + off + bj * HALF + n * 16) = v;
                        u32x2 w; w.x = cvt_pk_bf16(v[0], v[1]); w.y = cvt_pk_bf16(v[2], v[3]); *(u32x2*)(t1b + off + bj * HALF + n * 16) = w;
                        sa += (v[0] + v[1]) + (v[2] + v[3]); sq += (v[0] * v[0] + v[1] * v[1]) + (v[2] * v[2] + v[3] * v[3]); }
                sa += __shfl_xor(sa, 16); sa += __shfl_xor(sa, 32); sq += __shfl_xor(sq, 16); sq += __shfl_xor(sq, 32);
                if (fq == 0) *(f32x2v*)(stats + (size_t)row * 32 + slot * 2) = (f32x2v){sa, sq};
                if (m & 1) asm volatile("" ::: "memory"); }
    }
};
__device__ __forceinline__ void row_stats_1024(const float* stats, int row, float& mean, float& rstd) {
    const f32x4* p = (const f32x4*)(stats + (size_t)row * 32); float S = 0.f, Q = 0.f;
#pragma unroll
    for (int i = 0; i < 8; ++i) { const f32x4 v = p[i]; S += v[0] + v[2]; Q += v[1] + v[3]; }
    mean = S * (1.f / 1024.f); const float var = fmaxf(Q * (1.f / 1024.f) - mean * mean, 0.f); rstd = 1.0f / sqrtf(var + LN_EPS);
}
__device__ __forceinline__ void lane_row_stats(const float* stats, const Unit& u, int wr, int fr, int fq, float (&mu)[8], float (&rs)[8]) {
    float mym[2], myr[2];
#pragma unroll
    for (int jj = 0; jj < 2; ++jj) { const int idx = 2 * fq + jj; const int row = u.pm * BM + (idx >> 2) * HALF + wr * 64 + (idx & 3) * 16 + fr; row_stats_1024(stats, row, mym[jj], myr[jj]); asm volatile("" : "+v"(mym[jj]), "+v"(myr[jj]) :: "memory"); }
#pragma unroll
    for (int idx = 0; idx < 8; ++idx) { const int src = fr + 16 * (idx >> 1); mu[idx] = __shfl((idx & 1) ? mym[1] : mym[0], src); rs[idx] = __shfl((idx & 1) ? myr[1] : myr[0], src); }
}
struct EpiLnFold {
    static constexpr bool PERM = true, AFTER_DRAIN = false;
    bf16_t* O; int ldc; const float* cs; const float* bw; const float* stats; float scale; int scale_tiles;
    __device__ __forceinline__ void operator()(const f32x4 (&acc)[2][2][4][2], const Unit& u, int wr, int wc, int fr, int fq) const {
        float mu[8], rs[8]; lane_row_stats(stats, u, wr, fr, fq, mu, rs);
        const int row0 = u.pm * BM + wr * 64 + fr, col0 = u.pn * BM + wc * 32 + 8 * fq;
        const float sc = (u.pn < scale_tiles) ? scale : 1.f;
#pragma unroll
        for (int i = 0; i < 8; ++i) { rs[i] *= sc; mu[i] *= rs[i]; }
#pragma unroll
        for (int bj = 0; bj < 2; ++bj) {
            const f32x4 c0 = *(const f32x4*)(cs + col0 + bj * HALF), c1 = *(const f32x4*)(cs + col0 + bj * HALF + 4);
            const f32x4 b0 = *(const f32x4*)(bw + col0 + bj * HALF) * sc, b1 = *(const f32x4*)(bw + col0 + bj * HALF + 4) * sc;
#pragma unroll
            for (int ai = 0; ai < 2; ++ai)
#pragma unroll
                for (int m = 0; m < 4; ++m) { bf16_t* rowp = O + (size_t)(row0 + ai * HALF + m * 16) * ldc + col0; const float mm = mu[ai * 4 + m], rr = rs[ai * 4 + m];
                    const f32x4 v0 = acc[ai][bj][m][0] * rr - c0 * mm + b0, v1 = acc[ai][bj][m][1] * rr - c1 * mm + b1;
                    u32x4 w; w.x = cvt_pk_bf16(v0[0], v0[1]); w.y = cvt_pk_bf16(v0[2], v0[3]); w.z = cvt_pk_bf16(v1[0], v1[1]); w.w = cvt_pk_bf16(v1[2], v1[3]);
                    *(u32x4*)(rowp + bj * HALF) = w; }
            asm volatile("" ::: "memory");
        }
    }
};
struct EpiLnFoldT {
    static constexpr bool PERM = true, AFTER_DRAIN = false;
    bf16_t* O; int ldc; const float* cs; const float* bw; const float* stats;
    __device__ __forceinline__ void operator()(const f32x4 (&acc)[2][2][4][2], const Unit& u, int wr, int wc, int fr, int fq) const {
        const int row0 = u.pm * BM + wr * 64 + fr, col0 = u.pn * BM + wc * 32 + 8 * fq;
        float mym, myr; row_stats_1024(stats, col0 + (fr >> 3) * HALF + (fr & 7), mym, myr);
        float cc[8], bb[8];
#pragma unroll
        for (int i = 0; i < 8; ++i) { const int ch = row0 + (i >> 2) * HALF + (i & 3) * 16; cc[i] = cs[ch]; bb[i] = bw[ch]; }
#pragma unroll
        for (int bj = 0; bj < 2; ++bj) {
            f32x4 mt[2], rt[2];
#pragma unroll
            for (int n = 0; n < 2; ++n)
#pragma unroll
                for (int e = 0; e < 4; ++e) { const int src = fq * 16 + bj * 8 + 4 * n + e; mt[n][e] = __shfl(mym, src); rt[n][e] = __shfl(myr, src); }
#pragma unroll
            for (int ai = 0; ai < 2; ++ai)
#pragma unroll
                for (int m = 0; m < 4; ++m) { const int ch = row0 + ai * HALF + m * 16; bf16_t* rowp = O + (size_t)ch * ldc + col0; const float c1 = cc[ai * 4 + m], b1 = bb[ai * 4 + m];
                    const f32x4 v0 = (acc[ai][bj][m][0] - mt[0] * c1) * rt[0] + b1, v1 = (acc[ai][bj][m][1] - mt[1] * c1) * rt[1] + b1;
                    u32x4 w; w.x = cvt_pk_bf16(v0[0], v0[1]); w.y = cvt_pk_bf16(v0[2], v0[3]); w.z = cvt_pk_bf16(v1[0], v1[1]); w.w = cvt_pk_bf16(v1[2], v1[3]);
                    *(u32x4*)(rowp + bj * HALF) = w; }
            asm volatile("" ::: "memory");
        }
    }
};
struct EpiT2 {
    static constexpr bool PERM = false, AFTER_DRAIN = false;
    const float* t1; const float* stats; const float* g; const float* b; float* out; float alpha;
    __device__ __forceinline__ void operator()(const f32x4 (&acc)[2][2][4][2], const Unit& u, int wr, int wc, int fr, int fq) const {
        float mu[8], rs[8]; lane_row_stats(stats, u, wr, fr, fq, mu, rs);
        const int col0 = u.pn * BM + wc * 32 + 4 * fq;
        f32x4 gv[2][2], bv[2][2];
#pragma unroll
        for (int bj = 0; bj < 2; ++bj)
#pragma unroll
            for (int n = 0; n < 2; ++n) { gv[bj][n] = *(const f32x4*)(g + col0 + bj * HALF + n * 16) * alpha; bv[bj][n] = *(const f32x4*)(b + col0 + bj * HALF + n * 16) * alpha; }
#pragma unroll
        for (int ai = 0; ai < 2; ++ai)
#pragma unroll
            for (int m = 0; m < 4; ++m) { const int row = u.pm * BM + ai * HALF + wr * 64 + m * 16 + fr; const size_t off = (size_t)row * 1024 + col0; const float mm = mu[ai * 4 + m], rr = rs[ai * 4 + m];
#pragma unroll
                for (int bj = 0; bj < 2; ++bj)
#pragma unroll
                    for (int n = 0; n < 2; ++n) { const f32x4 tv = *(const f32x4*)(t1 + off + bj * HALF + n * 16);
                        *(f32x4*)(out + off + bj * HALF + n * 16) = ((tv - mm) * rr) * gv[bj][n] + bv[bj][n] + acc[ai][bj][m][n]; }
                if (m & 1) asm volatile("" ::: "memory"); }
    }
};
}

struct Args { const float* in[14]; float* out; unsigned char* ws; };

__device__ __forceinline__ void p0_transpose_item(const float* W, int ldw, int ncols, int K, bf16* WT, int row_off, const float* ksc, LAS float* scr, int item, int lane) {
    const int nblk = ncols / 32, kb = item / nblk, nb = item % nblk, k0 = 64 * kb, n0 = 32 * nb;
#pragma unroll 8
    for (int i = 0; i < 32; ++i) { const int kk = 2 * i + (lane >> 5); float v = W[(size_t)(k0 + kk) * ldw + n0 + (lane & 31)]; if (ksc) v *= ksc[k0 + kk]; scr[kk * 33 + (lane & 31)] = v; }
    LDS_WAIT(); asm volatile("" ::: "memory");
    const int c = lane & 7;
#pragma unroll
    for (int j = 0; j < 4; ++j) { const int n = (lane >> 3) + 8 * j; const LAS float* s = scr + (8 * c) * 33 + n;
        v4u o; o.x = pk2(s[0 * 33], s[1 * 33]); o.y = pk2(s[2 * 33], s[3 * 33]); o.z = pk2(s[4 * 33], s[5 * 33]); o.w = pk2(s[6 * 33], s[7 * 33]);
        *(GAS v4u*)(WT + (size_t)(row_off + n0 + n) * K + k0 + 8 * c) = o; }
    LDS_WAIT(); asm volatile("" ::: "memory");
}

constexpr int P2_WP = 0, P2_ROWB = 272, P2_VT = 128 * P2_ROWB, P2_VEC = P2_VT + 256 * P2_ROWB;
static_assert(P2_VEC + 5 * 512 <= RING_BYTES, "P2 LDS");

__device__ __forceinline__ void p2_chunk(unsigned char* lds, const float* gam, const float* bet, const float* wsp, const float* bsp, bf16* UZ, const bf16* VT, const float* VST, int chunk, int tid) {
    const int lane = tid & 63, wave = __builtin_amdgcn_readfirstlane(tid >> 6), fr = lane & 15, fq = lane >> 4, wr = wave >> 2, wc = wave & 3;
    float* mu_s = (float*)(lds + P2_VEC); float* rstd_s = mu_s + 128; float* m1_s = mu_s + 256; float* rsum_s = mu_s + 384; float* bsp_s = mu_s + 512;
    __syncthreads();
    if (tid < 128) { const f32x4* p = (const f32x4*)(VST + (size_t)(chunk * CH + tid) * 32); float S = 0.f, Q = 0.f;
#pragma unroll
        for (int i = 0; i < 8; ++i) { const f32x4 v = p[i]; S += v[0] + v[2]; Q += v[1] + v[3]; }
        const float mean = S * (1.f / 2048.f), var = fmaxf(Q * (1.f / 2048.f) - mean * mean, 0.f);
        mu_s[tid] = mean; rstd_s[tid] = 1.0f / sqrtf(var + LN_EPS); }
    for (int g = 0; g < NGRP; ++g) {
        __syncthreads();
        { const int t = tid >> 2, part = tid & 3; const float* wrow = wsp + ((size_t)g * CH + t) * CH + part * 32; float m1 = 0.f, rsm = 0.f;
          unsigned char* dst = lds + P2_WP + t * P2_ROWB + part * 64;
#pragma unroll
          for (int i = 0; i < 8; ++i) { const f32x4 w = *(const f32x4*)(wrow + 4 * i); float wp[4];
#pragma unroll
              for (int e = 0; e < 4; ++e) { const int s = part * 32 + 4 * i + e; const float wv = (s <= t) ? w[e] : 0.f; wp[e] = wv * rstd_s[s]; m1 += wp[e] * mu_s[s]; rsm += wv; }
              u32x2 pk; pk.x = pg8::cvt_pk_bf16(wp[0], wp[1]); pk.y = pg8::cvt_pk_bf16(wp[2], wp[3]); *(u32x2*)(dst + 8 * i) = pk; }
          m1 += __shfl_xor(m1, 1); m1 += __shfl_xor(m1, 2); rsm += __shfl_xor(rsm, 1); rsm += __shfl_xor(rsm, 2);
          if (part == 0) { m1_s[t] = m1; rsum_s[t] = rsm; bsp_s[t] = bsp[g * CH + t]; } }
        { const int row = tid >> 1, half = tid & 1; const bf16* src = VT + (size_t)(g * 256 + row) * MTOK + chunk * CH + half * 64; unsigned char* dst = lds + P2_VT + row * P2_ROWB + half * 128;
          v4u r[8];
#pragma unroll
          for (int i = 0; i < 8; ++i) r[i] = *(const v4u*)(src + 8 * i);
#pragma unroll
          for (int i = 0; i < 8; ++i) *(v4u*)(dst + 16 * i) = r[i]; }
        __syncthreads();
        f32x4 acc[4][4];
#pragma unroll
        for (int mt = 0; mt < 4; ++mt)
#pragma unroll
            for (int nt = 0; nt < 4; ++nt) acc[mt][nt] = (f32x4){0.f, 0.f, 0.f, 0.f};
#pragma unroll
        for (int ks = 0; ks < 4; ++ks) {
            if (32 * ks <= 64 * wr + 63) {
                bf16x8 af[4], bfr[4];
#pragma unroll
                for (int mt = 0; mt < 4; ++mt) af[mt] = *(const bf16x8*)(lds + P2_WP + (64 * wr + 16 * mt + fr) * P2_ROWB + 64 * ks + 16 * fq);
#pragma unroll
                for (int nt = 0; nt < 4; ++nt) bfr[nt] = *(const bf16x8*)(lds + P2_VT + (64 * wc + 16 * nt + fr) * P2_ROWB + 64 * ks + 16 * fq);
#pragma unroll
                for (int mt = 0; mt < 4; ++mt)
#pragma unroll
                    for (int nt = 0; nt < 4; ++nt) acc[mt][nt] = __builtin_amdgcn_mfma_f32_16x16x32_bf16(bfr[nt], af[mt], acc[mt][nt], 0, 0, 0);
            }
        }
#pragma unroll
        for (int mt = 0; mt < 4; ++mt) { const int t = 64 * wr + 16 * mt + fr; const float m1 = m1_s[t], rsm = rsum_s[t], bs = bsp_s[t];
            bf16* urow = UZ + (size_t)(chunk * CH + t) * 4096 + g * 256 + 64 * wc + 4 * fq;
#pragma unroll
            for (int nt = 0; nt < 4; ++nt) { const int cg = g * 256 + 64 * wc + 16 * nt + 4 * fq;
                const u32x2 uu = *(const u32x2*)(urow + 16 * nt), zz = *(const u32x2*)(urow + 2048 + 16 * nt);
                const f32x4 gv = *(const f32x4*)(gam + cg), bv = *(const f32x4*)(bet + cg); const f32x4 ac = acc[mt][nt];
                float y[4]; const float uf[4] = {bflo(uu.x), bfhi(uu.x), bflo(uu.y), bfhi(uu.y)}, zf[4] = {bflo(zz.x), bfhi(zz.x), bflo(zz.y), bfhi(zz.y)};
#pragma unroll
                for (int e = 0; e < 4; ++e) { const float sv = gv[e] * (ac[e] - m1) + bv[e] * rsm + bs; y[e] = uf[e] * sv * silu_f(zf[e]); }
                u32x2 pk; pk.x = pg8::cvt_pk_bf16(y[0], y[1]); pk.y = pg8::cvt_pk_bf16(y[2], y[3]); *(u32x2*)(urow + 16 * nt) = pk; } }
    }
}

constexpr int P5_KROW = 144, P5_VROW = 520, P5_K = 0, P5_V = 256 * P5_KROW, P5_BT = P5_V + 64 * P5_VROW;
static_assert(P5_BT + 8 * 192 * 4 <= RING_BYTES, "P5 LDS");
__device__ __forceinline__ int crow(int r, int hi) { return (r & 3) + 8 * (r >> 2) + 4 * hi; }
typedef __bf16 bf16x2_t __attribute__((ext_vector_type(2)));
__device__ __forceinline__ unsigned cvtpk_s(float lo, float hi) { f32x2v v = {lo, hi}; bf16x2_t b = __builtin_convertvector(v, bf16x2_t); return __builtin_bit_cast(unsigned, b); }

__device__ __forceinline__ void p5_unit(unsigned char* lds, const float* sinks, const float* relb, const bf16* QZ, const bf16* KV, const bf16* KVT, bf16* Y2, int b, int c, int kvh, int tid) {
    const int lane = tid & 63, wave = __builtin_amdgcn_readfirstlane(tid >> 6), ql = lane & 31, hh = lane >> 5;
    const long tok0 = (long)b * SEQ + (long)(c - 1) * CH;
    __syncthreads();
#pragma unroll
    for (int i = 0; i < 4; ++i) { const int p = tid + 512 * i, row = p >> 3, seg = p & 7; v4u v = (v4u){0u, 0u, 0u, 0u};
        if (c > 0 || row >= CH) v = *(const v4u*)(KV + (size_t)(tok0 + row) * 256 + kvh * 64 + seg * 8);
        *(v4u*)(lds + P5_K + row * P5_KROW + seg * 16) = v; }
#pragma unroll
    for (int i = 0; i < 4; ++i) { const int p = tid + 512 * i, row = p >> 5, seg = p & 31; v4u v = (v4u){0u, 0u, 0u, 0u};
        if (c > 0 || seg >= 16) v = *(const v4u*)(KVT + (size_t)(128 + kvh * 64 + row) * MTOK + (tok0 + seg * 8));
        u32x2 lo, hi; lo.x = v.x; lo.y = v.y; hi.x = v.z; hi.y = v.w;
        *(u32x2*)(lds + P5_V + row * P5_VROW + seg * 16) = lo; *(u32x2*)(lds + P5_V + row * P5_VROW + seg * 16 + 8) = hi; }
    float* btab = (float*)(lds + P5_BT);
#pragma unroll
    for (int i = 0; i < 3; ++i) { const int e = tid + 512 * i, hl = e / 192, d = e % 192 - 32; int bk;
        if (d < 16) bk = d < 0 ? 0 : d; else { bk = 16 + (int)(logf((float)d * (1.f / 16.f)) / logf(8.f) * 16.f); if (bk > 31) bk = 31; }
        btab[e] = relb[bk * 16 + kvh * 8 + hl] * LOG2E; }
    __syncthreads();
    const int h = kvh * 8 + wave; const float sink2 = sinks[h] * LOG2E; const float* bt = btab + wave * 192 + (ql - 4 * hh);
#pragma unroll 1
    for (int qb = 0; qb < 4; ++qb) {
        const long tq = (long)b * SEQ + (long)c * CH + 32 * qb;
        bf16x8 qf[4];
#pragma unroll
        for (int ks = 0; ks < 4; ++ks) qf[ks] = *(const bf16x8*)(QZ + (size_t)(tq + ql) * 2048 + h * 64 + 16 * ks + 8 * hh);
        f32x16 p[5];
#pragma unroll
        for (int kbi = 0; kbi < 5; ++kbi) { const unsigned char* kp = lds + P5_K + (32 * (qb + kbi) + ql) * P5_KROW + 16 * hh; f32x16 s = {};
#pragma unroll
            for (int ks = 0; ks < 4; ++ks) { const bf16x8 kf = *(const bf16x8*)(kp + 32 * ks); s = __builtin_amdgcn_mfma_f32_32x32x16_bf16(kf, qf[ks], s, 0, 0, 0); }
            p[kbi] = s; }
        float mx = sink2;
#pragma unroll
        for (int kbi = 0; kbi < 5; ++kbi)
#pragma unroll
            for (int r = 0; r < 16; ++r) { const int kib = crow(r, hh); const int d = 128 - 32 * kbi + ql - kib;
                bool valid = (kbi == 0) ? (d < 128) : ((kbi == 4) ? (d >= 0) : true);
                if (c == 0) valid = valid && (32 * (qb + kbi) + kib >= CH);
                const float v = valid ? p[kbi][r] + bt[160 - 32 * kbi - ((r & 3) + 8 * (r >> 2))] : -1e30f; p[kbi][r] = v; mx = fmaxf(mx, v); }
        mx = fmaxf(mx, __shfl_xor(mx, 32));
        float sum = 0.f;
#pragma unroll
        for (int kbi = 0; kbi < 5; ++kbi)
#pragma unroll
            for (int r = 0; r < 16; ++r) { const float e = __builtin_amdgcn_exp2f(p[kbi][r] - mx); p[kbi][r] = e; sum += e; }
        sum += __shfl_xor(sum, 32);
        const float inv = 1.f / (sum + __builtin_amdgcn_exp2f(sink2 - mx));
        f32x16 o0 = {}, o1 = {};
#pragma unroll
        for (int kbi = 0; kbi < 5; ++kbi)
#pragma unroll
            for (int s = 0; s < 2; ++s) { u32x4 pw;
                pw.x = cvtpk_s(p[kbi][8 * s + 0] * inv, p[kbi][8 * s + 1] * inv); pw.y = cvtpk_s(p[kbi][8 * s + 2] * inv, p[kbi][8 * s + 3] * inv);
                pw.z = cvtpk_s(p[kbi][8 * s + 4] * inv, p[kbi][8 * s + 5] * inv); pw.w = cvtpk_s(p[kbi][8 * s + 6] * inv, p[kbi][8 * s + 7] * inv);
                const bf16x8 pa = __builtin_bit_cast(bf16x8, pw);
                const unsigned char* vp = lds + P5_V + ql * P5_VROW + 2 * (32 * (qb + kbi) + 16 * s + 4 * hh);
                { const s16x4 lo = *(const s16x4*)(vp), hi = *(const s16x4*)(vp + 16); const bf16x8 vb = (bf16x8){lo[0], lo[1], lo[2], lo[3], hi[0], hi[1], hi[2], hi[3]};
                  o0 = __builtin_amdgcn_mfma_f32_32x32x16_bf16(pa, vb, o0, 0, 0, 0); }
                { const s16x4 lo = *(const s16x4*)(vp + 32 * P5_VROW), hi = *(const s16x4*)(vp + 32 * P5_VROW + 16); const bf16x8 vb = (bf16x8){lo[0], lo[1], lo[2], lo[3], hi[0], hi[1], hi[2], hi[3]};
                  o1 = __builtin_amdgcn_mfma_f32_32x32x16_bf16(pa, vb, o1, 0, 0, 0); } }
#pragma unroll
        for (int r = 0; r < 16; ++r) { const size_t tok = (size_t)(tq + crow(r, hh)); const int col = h * 64 + ql;
            const float z0 = bf2f(QZ[tok * 2048 + 1024 + col]), z1 = bf2f(QZ[tok * 2048 + 1024 + col + 32]);
            Y2[tok * 1024 + col] = (bf16)f2bf(o0[r] * silu_f(z0)); Y2[tok * 1024 + col + 32] = (bf16)f2bf(o1[r] * silu_f(z1)); }
    }
}

__global__ void __launch_bounds__(NWAVES * 64, 2) yoco_fwd(Args args) {
    extern __shared__ __attribute__((aligned(16))) unsigned char lds[];
    const int tid = threadIdx.x, lane = tid & 63, wave = __builtin_amdgcn_readfirstlane(tid >> 6);
    const int G = gridDim.x, bx = blockIdx.x, vcu = (G % 8 == 0) ? (bx % 8) * (G / 8) + bx / 8 : bx;
#define PHASE_BASE unsigned char* wsp = args.ws; asm volatile("" : "+s"(wsp)); int oz = 0; asm volatile("" : "+s"(oz));
#define ARG(i) (args.in[(i) + oz])
#define ctl ((gu32*)(wsp + WS_CTL))
#define WUZ ((bf16*)(wsp + WS_WUZ))
#define WV ((bf16*)(wsp + WS_WV))
#define WOA ((bf16*)(wsp + WS_WOA))
#define WQZ ((bf16*)(wsp + WS_WQZ))
#define WKV ((bf16*)(wsp + WS_WKV))
#define WOB ((bf16*)(wsp + WS_WOB))
#define CSQZ ((float*)(wsp + WS_VEC))
#define BWQZ (CSQZ + 2048)
#define CSKV (CSQZ + 4096)
#define BWKV (CSQZ + 4096 + 256)
#define VST ((float*)(wsp + WS_VST))
#define TST ((float*)(wsp + WS_TST))
#define XB ((bf16*)(wsp + WS_XB))
#define T1B XB
#define UZ ((bf16*)(wsp + WS_UZ))
#define QZ UZ
#define KV ((bf16*)(wsp + WS_UZ + 128 * MiB))
#define KVT ((bf16*)(wsp + WS_UZ + 144 * MiB))
#define Y2 ((bf16*)(wsp + WS_UZ + 160 * MiB))
#define VT ((bf16*)(wsp + WS_VT))
#define T1 ((float*)(wsp + WS_VT))
#define GRID_BARRIER() do { PHASE_BASE; (void)oz; XcdBarrier bar_; bar_.bar = (unsigned*)(ctl + CW_BAR); bar_.x = xb_xcc_id(); bar_.st = (volatile LAS unsigned*)((LAS unsigned char*)lds + MISC_OFF) + 8; xcd_barrier(bar_); } while (0)

    for (int u = tid; u < (LDS_BYTES - LDSCTL_OFF) / 4; u += NWAVES * 64) ((LAS unsigned*)((LAS unsigned char*)lds + LDSCTL_OFF))[u] = 0u;
    __syncthreads();
    { PHASE_BASE; (void)oz; (void)xcd_barrier_post((unsigned*)(ctl + CW_BAR), (volatile LAS unsigned*)((LAS unsigned char*)lds + MISC_OFF) + 8); }
    LAS unsigned char* ring = (LAS unsigned char*)lds;

    {
        PHASE_BASE; const float* x = ARG(0); const float* pg = ARG(12); const float* pb = ARG(13);
        LAS float* scr = (LAS float*)(ring + wave * 16384);
        const int gw = vcu * NWAVES + wave, NGW = G * NWAVES;
        const float* w_in_a = ARG(1); const float* w_out_a = ARG(6); const float* w_kv = ARG(7); const float* w_in_b = ARG(8); const float* w_out_b = ARG(11);
        constexpr int NITEMS = 3 * 1024 + 1024 + 1024 + 128 + 512;
        for (int it = gw; it < NITEMS; it += NGW) {
            int r = it;
            if (r < 1024) { p0_transpose_item(w_in_a, 6144, 2048, 1024, WUZ, 0, nullptr, scr, r, lane); continue; } r -= 1024;
            if (r < 1024) { p0_transpose_item(w_in_a + 4096, 6144, 2048, 1024, WUZ, 2048, nullptr, scr, r, lane); continue; } r -= 1024;
            if (r < 1024) { p0_transpose_item(w_in_a + 2048, 6144, 2048, 1024, WV, 0, nullptr, scr, r, lane); continue; } r -= 1024;
            if (r < 1024) { p0_transpose_item(w_out_a, 1024, 1024, 2048, WOA, 0, nullptr, scr, r, lane); continue; } r -= 1024;
            if (r < 1024) { p0_transpose_item(w_in_b, 2048, 2048, 1024, WQZ, 0, pg, scr, r, lane); continue; } r -= 1024;
            if (r < 128)  { p0_transpose_item(w_kv, 256, 256, 1024, WKV, 0, pg, scr, r, lane); continue; } r -= 128;
            p0_transpose_item(w_out_b, 1024, 1024, 1024, WOB, 0, nullptr, scr, r, lane);
        }
        for (int m = gw; m < MTOK; m += NGW) {
            const GAS f32x4* xr = (const GAS f32x4*)(x + (size_t)m * DM) + lane; GAS unsigned long long* o8 = (GAS unsigned long long*)(XB + (size_t)m * DM) + lane;
            f32x4 v[4];
#pragma unroll
            for (int j = 0; j < 4; ++j) v[j] = xr[64 * j];
#pragma unroll
            for (int j = 0; j < 4; ++j) o8[64 * j] = (unsigned long long)pk2(v[j].x, v[j].y) | ((unsigned long long)pk2(v[j].z, v[j].w) << 32);
        }
        for (int n = gw; n < 2304; n += NGW) {
            const float* W = (n < 2048) ? w_in_b + n : w_kv + (n - 2048); const int ldw = (n < 2048) ? 2048 : 256;
            float cs = 0.f, bw = 0.f;
#pragma unroll 4
            for (int i = 0; i < 16; ++i) { const int k = lane + 64 * i; const float w = W[(size_t)k * ldw]; cs += __builtin_bit_cast(float, f2bf(pg[k] * w) << 16); bw += pb[k] * w; }
            cs = wave_sum(cs); bw = wave_sum(bw);
            if (lane == 0) { if (n < 2048) { CSQZ[n] = cs; BWQZ[n] = bw; } else { CSKV[n - 2048] = cs; BWKV[n - 2048] = bw; } }
        }
    }
    GRID_BARRIER();

    {
        PHASE_BASE; (void)oz;
#ifndef SKIP_P1A
        { pg8::Gemm g{XB, WUZ, MTOK, 4096, DM, DM, DM}; pg8::StaticOrder S; S.init(MTOK, 4096, G, bx); pg8::EpiStore E{UZ, 4096};
          pg8::gemm_phase<pg8::EpiStore, pg8::StaticOrder, true, true>(ring, g, S, E); }
#endif
#ifndef SKIP_P1B
        { pg8::Gemm g{WV, XB, AW, MTOK, DM, DM, DM}; pg8::StaticOrder S; S.init(AW, MTOK, G, bx); pg8::EpiVT E{VT, MTOK, VST};
          pg8::gemm_phase<pg8::EpiVT, pg8::StaticOrder, true, true>(ring, g, S, E); }
#endif
    }
    GRID_BARRIER();

#ifndef SKIP_P2
    { PHASE_BASE;
    for (int chunk = vcu; chunk < MTOK / CH; chunk += G) p2_chunk(lds, ARG(2), ARG(3), ARG(4), ARG(5), UZ, VT, VST, chunk, tid); }
#endif
    GRID_BARRIER();

#ifndef SKIP_P3
    { PHASE_BASE; const float* x = ARG(0); pg8::Gemm g{UZ, WOA, MTOK, DM, AW, 4096, AW}; pg8::StaticOrder S; S.init(MTOK, DM, G, bx); pg8::EpiT1 E{x, T1, T1B, TST, ALPHA};
      pg8::gemm_phase<pg8::EpiT1, pg8::StaticOrder, true, true>(ring, g, S, E); }
#endif
    GRID_BARRIER();

    {
        PHASE_BASE; (void)oz;
#ifndef SKIP_P4A
        { pg8::Gemm g{T1B, WQZ, MTOK, 2048, DM, DM, DM}; pg8::StaticOrder S; S.init(MTOK, 2048, G, bx); pg8::EpiLnFold E{QZ, 2048, CSQZ, BWQZ, TST, QSCALE, 4};
          pg8::gemm_phase<pg8::EpiLnFold, pg8::StaticOrder, true, true>(ring, g, S, E); }
#endif
#ifndef SKIP_P4B
#ifndef SKIP_P4B1
        if (bx < G / 2) { pg8::Gemm g{T1B, WKV, MTOK, 256, DM, DM, DM}; pg8::StaticOrder S; S.init(MTOK, 256, G / 2, bx); pg8::EpiLnFold E{KV, 256, CSKV, BWKV, TST, 1.f, 0};
          pg8::gemm_phase<pg8::EpiLnFold, pg8::StaticOrder, true, true>(ring, g, S, E); }
#endif
#ifndef SKIP_P4B2
        if (bx >= G / 2) { pg8::Gemm g{WKV, T1B, 256, MTOK, DM, DM, DM}; pg8::StaticOrder S; S.init(256, MTOK, G - G / 2, bx - G / 2); pg8::EpiLnFoldT E{KVT, MTOK, CSKV, BWKV, TST};
          pg8::gemm_phase<pg8::EpiLnFoldT, pg8::StaticOrder, true, true>(ring, g, S, E); }
#endif
#endif
    }
    GRID_BARRIER();

#ifndef SKIP_P5
    { PHASE_BASE; const float* sinks = ARG(9); const float* relb = ARG(10);
    for (int bc = vcu; bc < MTOK / CH; bc += G) { const int b = bc / (SEQ / CH), c = bc % (SEQ / CH);
#pragma unroll 1
        for (int kvh = 0; kvh < 2; ++kvh) p5_unit(lds, sinks, relb, QZ, KV, KVT, Y2, b, c, kvh, tid); } }
#endif
    GRID_BARRIER();

#ifndef SKIP_P6
    { PHASE_BASE; const float* pg = ARG(12); const float* pb = ARG(13); pg8::Gemm g{Y2, WOB, MTOK, DM, DM, DM, DM}; pg8::StaticOrder S; S.init(MTOK, DM, G, bx); pg8::EpiT2 E{T1, TST, pg, pb, args.out, ALPHA};
      pg8::gemm_phase<pg8::EpiT2, pg8::StaticOrder, true, true>(ring, g, S, E); }
#endif
    GRID_BARRIER();

    {
        PHASE_BASE; (void)wsp; const float* pg = ARG(12); const float* pb = ARG(13);
        const int gw = vcu * NWAVES + wave, NGW = G * NWAVES; const float* g2 = pg + DM; const float* b2 = pb + DM;
        f32x4 gg[4], bb[4];
#pragma unroll
        for (int j = 0; j < 4; ++j) { gg[j] = ((const f32x4*)g2)[lane + 64 * j]; bb[j] = ((const f32x4*)b2)[lane + 64 * j]; }
        for (int m = gw; m < MTOK; m += NGW) {
            GAS f32x4* xr = (GAS f32x4*)(args.out + (size_t)m * DM) + lane; f32x4 v[4]; float s = 0.f;
#pragma unroll
            for (int j = 0; j < 4; ++j) { v[j] = xr[64 * j]; s += (v[j].x + v[j].y) + (v[j].z + v[j].w); }
            const float mean = wave_sum(s) * (1.f / DM); float s2 = 0.f;
#pragma unroll
            for (int j = 0; j < 4; ++j) { v[j] = v[j] - mean; s2 += (v[j].x * v[j].x + v[j].y * v[j].y) + (v[j].z * v[j].z + v[j].w * v[j].w); }
            const float rstd = 1.f / sqrtf(wave_sum(s2) * (1.f / DM) + LN_EPS);
#pragma unroll
            for (int j = 0; j < 4; ++j) xr[64 * j] = v[j] * rstd * gg[j] + bb[j];
        }
    }
}

extern "C" void kernel_launch(void* const* d_in, const int* in_sizes, int n_in, void* d_out, int out_size, void* d_ws, size_t ws_size, hipStream_t stream) {
    static int grid = 0;
    if (grid == 0) {
        if (n_in != 14 || in_sizes[0] != MTOK * DM || out_size != MTOK * DM || ws_size < WS_END) { fprintf(stderr, "kernel_launch: unexpected shapes / workspace (%d inputs, in0 %d, out %d, ws %zu); nothing launched\n", n_in, n_in > 0 ? in_sizes[0] : -1, out_size, ws_size); grid = -1; return; }
        int dev = 0, cus = 0;
        if (hipGetDevice(&dev) != hipSuccess || hipDeviceGetAttribute(&cus, hipDeviceAttributeMultiprocessorCount, dev) != hipSuccess) { grid = -1; return; }
        if (hipFuncSetAttribute((const void*)yoco_fwd, hipFuncAttributeMaxDynamicSharedMemorySize, LDS_BYTES) != hipSuccess) { fprintf(stderr, "kernel_launch: hipFuncSetAttribute failed\n"); grid = -1; return; }
        int per_cu = 0;
        if (hipOccupancyMaxActiveBlocksPerMultiprocessor(&per_cu, (const void*)yoco_fwd, NWAVES * 64, LDS_BYTES) != hipSuccess || per_cu < 1) fprintf(stderr, "kernel_launch: occupancy query reports %d\n", per_cu);
        (void)hipGetLastError();
        grid = (cus / 8) * 8;
        if (grid > 256) grid = 256;
    }
    if (grid <= 0) return;
    if (hipMemsetAsync((char*)d_ws + WS_CTL, 0, CTL_ZERO_BYTES, stream) != hipSuccess) return;
    Args a{};
    for (int i = 0; i < 14; ++i) a.in[i] = (const float*)d_in[i];
    a.out = (float*)d_out; a.ws = (unsigned char*)d_ws;
    hipLaunchKernelGGL(yoco_fwd, dim3(grid), dim3(NWAVES * 64), LDS_BYTES, stream, a);
}
```
